# Optimizing an MI355X kernel written in HIP

```python
import math
import jax, jax.numpy as jnp
from jax import lax
import numpy as np

D_MODEL = 2048
BATCH = 4
SEQ = 2048
DEPTH = 2
DEC_BATCH = 128
DEC_SEQ = 4
PAST_LEN = 16384
PAGE_SIZE = 128

N_MIXERS = 2
N_SSM_LAYERS = (DEPTH + 1) // 2
N_GMLP_LAYERS = DEPTH // 2
SSM_GROUP = 16
SSM_GROUPS = D_MODEL // SSM_GROUP
SSM_STATE = 64
DT_MIN = 0.001
DT_MAX = 0.1
CHUNK = 128
GMLP_WIDTH = D_MODEL
GMLP_HEADS = 16
GMLP_HEAD_DIM = GMLP_WIDTH // GMLP_HEADS
FFN_HIDDEN = ((8 * D_MODEL + 3 * 256 - 1) // (3 * 256)) * 256
EPS = 1e-6

kernel_name = "hybrid_s5_gmlp_decoder_step"


def rms_norm(x, g):
    xf = x.astype(jnp.float32)
    y = xf * lax.rsqrt(jnp.mean(xf * xf, axis=-1, keepdims=True) + EPS)
    return (y * g.astype(jnp.float32)).astype(x.dtype)


def layer_norm(x, g):
    xf = x.astype(jnp.float32)
    xc = xf - jnp.mean(xf, axis=-1, keepdims=True)
    y = xc * lax.rsqrt(jnp.mean(xc * xc, axis=-1, keepdims=True) + EPS)
    return (y * g.astype(jnp.float32)).astype(x.dtype)


def ssm_discretize(lambda_re, lambda_im, log_dt, b_re, b_im):
    dt = jnp.exp(log_dt.astype(jnp.float32))[:, None]
    lr = lambda_re.astype(jnp.float32)
    li = lambda_im.astype(jnp.float32)
    mag = jnp.exp(lr * dt)
    a_re = mag * jnp.cos(li * dt)
    a_im = mag * jnp.sin(li * dt)
    den = lr * lr + li * li
    nr = a_re - 1.0
    ni = a_im
    q_re = (nr * lr + ni * li) / den
    q_im = (ni * lr - nr * li) / den
    br = b_re.astype(jnp.float32)
    bi = b_im.astype(jnp.float32)
    bb_re = q_re[..., None] * br - q_im[..., None] * bi
    bb_im = q_re[..., None] * bi + q_im[..., None] * br
    return a_re, a_im, bb_re, bb_im


def ssm_combine(e1, e2):
    a1r, a1i, b1r, b1i = e1
    a2r, a2i, b2r, b2i = e2
    ar = a2r * a1r - a2i * a1i
    ai = a2r * a1i + a2i * a1r
    br = a2r * b1r - a2i * b1i + b2r
    bi = a2r * b1i + a2i * b1r + b2i
    return (ar, ai, br, bi)


def ssm_mixer(h, h0_re, h0_im, w_in, lambda_re, lambda_im, log_dt, b_re, b_im, c_re, c_im, d_skip, w_out):
    bsz, t, _ = h.shape
    u = (h @ w_in).astype(jnp.float32).reshape(bsz, t, SSM_GROUPS, SSM_GROUP)
    a_re, a_im, bb_re, bb_im = ssm_discretize(lambda_re, lambda_im, log_dt, b_re, b_im)
    bu_re = jnp.einsum('btgc,gpc->btgp', u, bb_re)
    bu_im = jnp.einsum('btgc,gpc->btgp', u, bb_im)
    s_re = h0_re.astype(jnp.float32)
    s_im = h0_im.astype(jnp.float32)
    bu_re = bu_re.at[:, 0].add(a_re * s_re - a_im * s_im)
    bu_im = bu_im.at[:, 0].add(a_re * s_im + a_im * s_re)
    ar = jnp.broadcast_to(a_re, bu_re.shape)
    ai = jnp.broadcast_to(a_im, bu_im.shape)
    _, _, st_re, st_im = lax.associative_scan(ssm_combine, (ar, ai, bu_re, bu_im), axis=1)
    y = (jnp.einsum('btgp,gcp->btgc', st_re, c_re.astype(jnp.float32))
         - jnp.einsum('btgp,gcp->btgc', st_im, c_im.astype(jnp.float32)))
    y = y.reshape(bsz, t, D_MODEL) + d_skip.astype(jnp.float32) * u.reshape(bsz, t, D_MODEL)
    z = jax.nn.gelu(y).astype(h.dtype)
    zo = z @ w_out
    out = zo[..., :D_MODEL] * jax.nn.sigmoid(zo[..., D_MODEL:])
    return out, st_re[:, -1], st_im[:, -1]


def gmlp_mixer(h, w_in, v_gain, w_spatial, b_spatial, w_out):
    bsz, t, _ = h.shape
    z = jax.nn.gelu(h @ w_in)
    u = z[..., :GMLP_WIDTH]
    v = layer_norm(z[..., GMLP_WIDTH:], v_gain)
    n_chunks = -(-t // CHUNK)
    pad = n_chunks * CHUNK - t
    vp = jnp.pad(v, ((0, 0), (0, pad), (0, 0))).reshape(bsz, n_chunks, CHUNK, GMLP_HEADS, GMLP_HEAD_DIM)
    mask = jnp.tril(jnp.ones((CHUNK, CHUNK), dtype=bool))
    ws = jnp.where(mask[None], w_spatial, jnp.zeros((), w_spatial.dtype))
    s = jnp.einsum('hqk,bnkhd->bnqhd', ws, vp) + jnp.transpose(b_spatial)[None, None, :, :, None]
    s = s.reshape(bsz, n_chunks * CHUNK, GMLP_WIDTH)[:, :t]
    out = (u * s) @ w_out
    return out, v


def swiglu(h, w_gate_up, w_down):
    gu = h @ w_gate_up
    return (jax.nn.silu(gu[..., :FFN_HIDDEN]) * gu[..., FFN_HIDDEN:]) @ w_down


def trunk(x, h0_re, h0_im, p):
    new_re, new_im, new_v = [], [], []
    for i in range(DEPTH):
        j = i // N_MIXERS
        hn = rms_norm(x, p['norm_mix'][i])
        if i % N_MIXERS == 0:
            mix, sr, si = ssm_mixer(hn, h0_re[j], h0_im[j], p['ssm_w_in'][j], p['ssm_lambda_re'][j],
                                    p['ssm_lambda_im'][j], p['ssm_log_dt'][j], p['ssm_b_re'][j],
                                    p['ssm_b_im'][j], p['ssm_c_re'][j], p['ssm_c_im'][j],
                                    p['ssm_d'][j], p['ssm_w_out'][j])
            new_re.append(sr)
            new_im.append(si)
        else:
            mix, v = gmlp_mixer(hn, p['gmlp_w_in'][j], p['gmlp_v_gain'][j], p['gmlp_w_spatial'][j],
                                p['gmlp_b_spatial'][j], p['gmlp_w_out'][j])
            new_v.append(v)
        x = x + mix
        x = x + swiglu(rms_norm(x, p['norm_ffn'][i]), p['ffn_w_gate_up'][i], p['ffn_w_down'][i])
    return rms_norm(x, p['norm_final']), jnp.stack(new_re), jnp.stack(new_im), jnp.stack(new_v)


def setup_inputs(seed: int = 0) -> dict:
    key = jax.random.key(seed)
    ks = jax.random.split(key, 24)
    f32 = jnp.float32
    nA, nB, G, P, C = N_SSM_LAYERS, N_GMLP_LAYERS, SSM_GROUPS, SSM_STATE, SSM_GROUP
    nrm = lambda k, shape, s: jax.random.normal(k, shape, f32) * s
    lambda_re = -0.5 + nrm(ks[4], (nA, G, P), 0.01)
    lambda_im = math.pi * jnp.arange(P, dtype=f32)[None, None, :] + nrm(ks[5], (nA, G, P), 0.01)
    log_dt = jax.random.uniform(ks[6], (nA, G), f32, math.log(DT_MIN), math.log(DT_MAX))
    return {
        'x_prompt': nrm(ks[0], (BATCH, SEQ, D_MODEL), 1.0),
        'x_sample': nrm(ks[1], (DEC_BATCH, DEC_SEQ, D_MODEL), 1.0),
        'state_ssm_re': nrm(ks[2], (nA, DEC_BATCH, G, P), 0.5),
        'state_ssm_im': nrm(ks[3], (nA, DEC_BATCH, G, P), 0.5),
        'norm_mix': 1.0 + nrm(ks[7], (DEPTH, D_MODEL), 0.02),
        'norm_ffn': 1.0 + nrm(ks[8], (DEPTH, D_MODEL), 0.02),
        'norm_final': 1.0 + nrm(ks[9], (D_MODEL,), 0.02),
        'ssm_w_in': nrm(ks[10], (nA, D_MODEL, D_MODEL), D_MODEL ** -0.5),
        'ssm_lambda_re': lambda_re,
        'ssm_lambda_im': lambda_im,
        'ssm_log_dt': log_dt,
        'ssm_b_re': nrm(ks[11], (nA, G, P, C), (2.0 * C) ** -0.5),
        'ssm_b_im': nrm(ks[12], (nA, G, P, C), (2.0 * C) ** -0.5),
        'ssm_c_re': nrm(ks[13], (nA, G, C, P), (2.0 * P) ** -0.5),
        'ssm_c_im': nrm(ks[14], (nA, G, C, P), (2.0 * P) ** -0.5),
        'ssm_d': nrm(ks[15], (nA, D_MODEL), 1.0),
        'ssm_w_out': nrm(ks[16], (nA, D_MODEL, 2 * D_MODEL), D_MODEL ** -0.5),
        'gmlp_w_in': nrm(ks[17], (nB, D_MODEL, 2 * GMLP_WIDTH), D_MODEL ** -0.5),
        'gmlp_v_gain': 1.0 + nrm(ks[18], (nB, GMLP_WIDTH), 0.02),
        'gmlp_w_spatial': nrm(ks[19], (nB, GMLP_HEADS, CHUNK, CHUNK), CHUNK ** -0.5),
        'gmlp_b_spatial': 1.0 + nrm(ks[20], (nB, GMLP_HEADS, CHUNK), 0.02),
        'gmlp_w_out': nrm(ks[21], (nB, GMLP_WIDTH, D_MODEL), GMLP_WIDTH ** -0.5),
        'ffn_w_gate_up': nrm(ks[22], (DEPTH, D_MODEL, 2 * FFN_HIDDEN), D_MODEL ** -0.5),
        'ffn_w_down': nrm(ks[23], (DEPTH, FFN_HIDDEN, D_MODEL), FFN_HIDDEN ** -0.5),
    }


def reference(x_prompt, x_sample, state_ssm_re, state_ssm_im, norm_mix, norm_ffn, norm_final,
              ssm_w_in, ssm_lambda_re, ssm_lambda_im, ssm_log_dt, ssm_b_re, ssm_b_im, ssm_c_re, ssm_c_im,
              ssm_d, ssm_w_out, gmlp_w_in, gmlp_v_gain, gmlp_w_spatial, gmlp_b_spatial, gmlp_w_out,
              ffn_w_gate_up, ffn_w_down):
    p = dict(norm_mix=norm_mix, norm_ffn=norm_ffn, norm_final=norm_final,
             ssm_w_in=ssm_w_in, ssm_lambda_re=ssm_lambda_re, ssm_lambda_im=ssm_lambda_im,
             ssm_log_dt=ssm_log_dt, ssm_b_re=ssm_b_re, ssm_b_im=ssm_b_im, ssm_c_re=ssm_c_re,
             ssm_c_im=ssm_c_im, ssm_d=ssm_d, ssm_w_out=ssm_w_out,
             gmlp_w_in=gmlp_w_in, gmlp_v_gain=gmlp_v_gain, gmlp_w_spatial=gmlp_w_spatial,
             gmlp_b_spatial=gmlp_b_spatial, gmlp_w_out=gmlp_w_out,
             ffn_w_gate_up=ffn_w_gate_up, ffn_w_down=ffn_w_down)
    zeros = jnp.zeros((N_SSM_LAYERS, x_prompt.shape[0], SSM_GROUPS, SSM_STATE), jnp.float32)
    y_prompt, new_ssm_re_prompt, new_ssm_im_prompt, _ = trunk(x_prompt, zeros, zeros, p)
    y_sample, new_ssm_re_sample, new_ssm_im_sample, new_gmlp_v_sample = trunk(x_sample, state_ssm_re, state_ssm_im, p)
    return (y_prompt, y_sample, new_ssm_re_prompt, new_ssm_im_prompt,
            new_ssm_re_sample, new_ssm_im_sample, new_gmlp_v_sample)
```

```cpp
#include <hip/hip_runtime.h>
#include <hip/hip_cooperative_groups.h>
#include <cstdio>
namespace cg = cooperative_groups;

#define LAS __attribute__((address_space(3)))
typedef unsigned short bf16_t;
typedef short bf16x8 __attribute__((ext_vector_type(8)));
typedef float f32x4 __attribute__((ext_vector_type(4)));
typedef float f32x2 __attribute__((ext_vector_type(2)));
typedef unsigned u32x4 __attribute__((ext_vector_type(4)));
typedef unsigned u32x2 __attribute__((ext_vector_type(2)));

#ifndef N_LAUNCH_MODE
#define N_LAUNCH_MODE 0
#endif

constexpr int D = 2048, MP = 8192, MS = 512, M = MP + MS, FF = 5632, NGU = 2 * FF;
constexpr int SEQ = 2048, NG = 128, NP = 64, NC = 16, NCHUNK = 16, CH = 128;
constexpr float EPS = 1e-6f;
constexpr int NPHASE = 13;

constexpr size_t al256(size_t x) { return (x + 255) & ~(size_t)255; }
constexpr size_t WS_STATS = 0;
constexpr size_t WS_ATAB  = al256(WS_STATS + (size_t)7 * M * 4);
constexpr size_t WS_BBT   = al256(WS_ATAB + (size_t)NG * NP * 8);
constexpr size_t WS_CMT   = al256(WS_BBT + (size_t)NG * 128 * 16 * 2);
constexpr size_t WS_SLOC  = al256(WS_CMT + (size_t)NG * 16 * 128 * 2);
constexpr size_t WS_XB    = al256(WS_SLOC + (size_t)4 * NG * 16 * NP * 8);
constexpr size_t WS_U     = al256(WS_XB + (size_t)M * D * 2);
constexpr size_t WS_Z     = al256(WS_U + (size_t)M * D * 2);
constexpr size_t WS_H     = al256(WS_Z + (size_t)M * D * 2);
constexpr size_t WS_W1    = al256(WS_H + (size_t)M * FF * 2);
constexpr size_t WS_W2    = al256(WS_W1 + (size_t)D * D * 2);
constexpr size_t WS_WGU0  = al256(WS_W2 + (size_t)2 * D * D * 2);
constexpr size_t WS_WD0   = al256(WS_WGU0 + (size_t)NGU * D * 2);
constexpr size_t WS_W5    = al256(WS_WD0 + (size_t)D * FF * 2);
constexpr size_t WS_W6    = al256(WS_W5 + (size_t)2 * D * D * 2);
constexpr size_t WS_WGU1  = al256(WS_W6 + (size_t)D * D * 2);
constexpr size_t WS_WD1   = al256(WS_WGU1 + (size_t)NGU * D * 2);
constexpr size_t WS_END   = al256(WS_WD1 + (size_t)D * FF * 2);
static_assert((size_t)M * D * 4 <= (size_t)M * FF * 2, "zv alias");

constexpr size_t O_Y = 0, O_RE_P = (size_t)M * D, O_IM_P = O_RE_P + 4 * NG * NP, O_RE_S = O_IM_P + 4 * NG * NP,
                 O_IM_S = O_RE_S + (size_t)128 * NG * NP, O_V = O_IM_S + (size_t)128 * NG * NP;

struct Args { const float* in[24]; float* out; unsigned char* ws; int ph_lo, ph_hi; };

__device__ __forceinline__ unsigned cvt_pk_bf16(float lo, float hi) { unsigned r; asm volatile("v_cvt_pk_bf16_f32 %0, %1, %2" : "=v"(r) : "v"(lo), "v"(hi)); return r; }
__device__ __forceinline__ float bf_lo(unsigned w) { return __uint_as_float(w << 16); }
__device__ __forceinline__ float bf_hi(unsigned w) { return __uint_as_float(w & 0xffff0000u); }
__device__ __forceinline__ float sigmoid_f(float x) { return __builtin_amdgcn_rcpf(1.0f + __expf(-x)); }
__device__ __forceinline__ float gelu_tanh(float x) { const float t = 1.5957691216057308f * (x + 0.044715f * x * x * x); return x * sigmoid_f(t); }
__device__ __forceinline__ float silu_f(float x) { return x * sigmoid_f(x); }
__device__ __forceinline__ float wave_sum(float v) {
#pragma unroll
    for (int o = 32; o >= 1; o >>= 1) v += __shfl_xor(v, o);
    return v;
}

namespace pg8 {
constexpr int BM = 256, BK = 64, HALF = 128, HTB = HALF * BK * 2, STAGE_BYTES = 8 * HTB, NXCD = 8, WGM = 8;
__device__ __forceinline__ int lds_byte(int r, int c) { const int st = (r >> 4) * 2 + (c >> 5), rr = r & 15, cc = c & 31, ob = rr * 64 + cc * 2; return st * 1024 + (ob ^ (((ob >> 9) & 1) << 5)); }
__device__ __forceinline__ void stage_rc(int b, int& R, int& C) { const int st = b / 1024, sb = b % 1024, swz = sb ^ (((sb >> 9) & 1) << 5); R = (st >> 1) * 16 + swz / 64; C = (st & 1) * 32 + (swz % 64) / 2; }
__device__ __forceinline__ int perm32(int rho) { const int n = rho >> 4, i = rho & 15; return 8 * (i >> 2) + 4 * n + (i & 3); }

struct Unit { int pm, pn; };
struct Gemm { const bf16_t* A; const bf16_t* Bt; int M, N, K; };
struct StaticOrder {
    int nM, nN, nwg, G, c;
    __device__ void init(int M_, int N_, int G_, int c_) { nM = M_ / BM; nN = N_ / BM; nwg = nM * nN; G = G_; c = c_; }
    __device__ bool next(int i, Unit& u) const {
        const long L = (long)i * G + c; if (L >= nwg) return false;
        int wgid = (int)L; { const int q = nwg / NXCD, r = nwg % NXCD, xcd = wgid % NXCD, off = wgid / NXCD; wgid = (xcd < r ? xcd * (q + 1) : r * (q + 1) + (xcd - r) * q) + off; }
        const int nig = WGM * nN, gid = wgid / nig, fm = gid * WGM, gsz = (nM - fm) < WGM ? (nM - fm) : WGM;
        u.pm = fm + ((wgid % nig) % gsz); u.pn = (wgid % nig) / gsz; return true;
    }
};

template <class Epi>
__device__ __forceinline__ void gemm_phase(LAS unsigned char* lds, const Gemm g, const StaticOrder& S, const Epi& E) {
    const int tid = threadIdx.x, wid = __builtin_amdgcn_readfirstlane(tid >> 6), lane = tid & 63, wr = wid >> 2, wc = wid & 3, fr = lane & 15, fq = lane >> 4;
    const int K = g.K, nt = K / BK;
    unsigned voffA[2], voffB[2];
#pragma unroll
    for (int i = 0; i < 2; ++i) { int R, C; stage_rc(tid * 16 + i * 8192, R, C); const int Rb = (R & ~31) + perm32(R & 31);
        voffA[i] = (unsigned)(R * K + C) * 2u; voffB[i] = (unsigned)(Rb * K + C) * 2u; }
    const size_t kstep = (size_t)(BK * 2);
    const size_t hstep = (size_t)HALF * K * 2;
    const size_t tstep = 2 * hstep;
    const unsigned ldsw = (unsigned)wid * 1024u;
    const int aoff = lds_byte(wr * 64 + fr, fq * 8), boff = lds_byte(wc * 32 + fr, fq * 8);
#define PG8_SA(b, h) (((b) * 2 + (h)) * HTB)
#define PG8_SB(b, h) ((4 + (b) * 2 + (h)) * HTB)
#define PG8_STAGE(bufoff, gbase, voff) do { _Pragma("unroll") for (int _i = 0; _i < 2; ++_i) \
        __builtin_amdgcn_global_load_lds((const unsigned*)((const char*)(gbase) + (voff)[_i]), (LAS unsigned*)(lds + (bufoff) + ldsw + _i * 8192), 16, 0, 0); } while (0)
#define PG8_LDA(dst, b, h) do { _Pragma("unroll") for (int m = 0; m < 4; ++m) _Pragma("unroll") for (int k = 0; k < 2; ++k) dst[m][k] = *(const LAS bf16x8*)(lds + PG8_SA(b, h) + aoff + m * 2048 + k * 1024); } while (0)
#define PG8_LDB(dst, b, h) do { _Pragma("unroll") for (int n = 0; n < 2; ++n) _Pragma("unroll") for (int k = 0; k < 2; ++k) dst[n][k] = *(const LAS bf16x8*)(lds + PG8_SB(b, h) + boff + n * 2048 + k * 1024); } while (0)
#define PG8_MMA(ai, bj, At, Bt) do { __builtin_amdgcn_s_setprio(1); _Pragma("unroll") for (int m = 0; m < 4; ++m) _Pragma("unroll") for (int n = 0; n < 2; ++n) _Pragma("unroll") for (int k = 0; k < 2; ++k) \
        acc[ai][bj][m][n] = __builtin_amdgcn_mfma_f32_16x16x32_bf16(Bt[n][k], At[m][k], acc[ai][bj][m][n], 0, 0, 0); __builtin_amdgcn_s_setprio(0); } while (0)
#define PG8_WAIT_V(n) asm volatile("s_waitcnt vmcnt(" #n ")" ::: "memory")
#define PG8_WAIT_L(n) asm volatile("s_waitcnt lgkmcnt(" #n ")" ::: "memory")
#define PG8_BAR __builtin_amdgcn_s_barrier()
#define PG8_SCHED __builtin_amdgcn_sched_barrier(0)
    Unit cur, nxt; int ui = 0;
    if (!S.next(0, cur)) return;
    f32x4 acc[2][2][4][2];
#pragma unroll
    for (int a = 0; a < 2; ++a)
#pragma unroll
        for (int b = 0; b < 2; ++b)
#pragma unroll
            for (int m = 0; m < 4; ++m)
#pragma unroll
                for (int n = 0; n < 2; ++n) acc[a][b][m][n] = (f32x4){0.f, 0.f, 0.f, 0.f};
    bf16x8 At[4][2], B0[2][2], B1[2][2];
    const char* cA = (const char*)g.A + (size_t)cur.pm * tstep; const char* cB = (const char*)g.Bt + (size_t)cur.pn * tstep;
    PG8_STAGE(PG8_SB(0, 0), cB, voffB); PG8_STAGE(PG8_SA(0, 0), cA, voffA); PG8_STAGE(PG8_SB(0, 1), cB + hstep, voffB); PG8_STAGE(PG8_SA(0, 1), cA + hstep, voffA);
    if (wr == 1) PG8_BAR;
    PG8_WAIT_V(4); PG8_BAR;
    PG8_STAGE(PG8_SB(1, 0), cB + kstep, voffB); PG8_STAGE(PG8_SA(1, 0), cA + kstep, voffA); PG8_STAGE(PG8_SB(1, 1), cB + hstep + kstep, voffB);
    PG8_WAIT_V(6); PG8_BAR;
    for (;;) {
        const bool has_next = S.next(ui + 1, nxt);
        const char* nA = has_next ? (const char*)g.A + (size_t)nxt.pm * tstep : cA; const char* nB = has_next ? (const char*)g.Bt + (size_t)nxt.pn * tstep : cB;
        for (int t = 0; t < nt; t += 2) {
            const bool last = (t == nt - 2);
            const char* a1 = cA + (size_t)(t + 1) * kstep;
            const char* a2 = last ? nA : cA + (size_t)(t + 2) * kstep; const char* b2 = last ? nB : cB + (size_t)(t + 2) * kstep;
            const char* a3 = a2 + kstep; const char* b3 = b2 + kstep;
            PG8_LDB(B0, 0, 0); PG8_SCHED; PG8_LDA(At, 0, 0); PG8_STAGE(PG8_SA(1, 1), a1 + hstep, voffA);
            PG8_WAIT_L(8); PG8_BAR; PG8_WAIT_L(0); PG8_MMA(0, 0, At, B0); PG8_BAR; PG8_SCHED;
            PG8_LDB(B1, 0, 1); PG8_STAGE(PG8_SB(0, 0), b2, voffB);
            PG8_BAR; PG8_WAIT_L(0); PG8_MMA(0, 1, At, B1); PG8_BAR;
            PG8_LDA(At, 0, 1); PG8_STAGE(PG8_SA(0, 0), a2, voffA);
            PG8_BAR; PG8_WAIT_L(0); PG8_MMA(1, 0, At, B0); PG8_BAR; PG8_SCHED;
            PG8_STAGE(PG8_SB(0, 1), b2 + hstep, voffB);
            PG8_WAIT_V(6); PG8_BAR; PG8_MMA(1, 1, At, B1); PG8_BAR;
            PG8_LDB(B0, 1, 0); PG8_SCHED; PG8_LDA(At, 1, 0); PG8_STAGE(PG8_SA(0, 1), a2 + hstep, voffA);
            PG8_WAIT_L(8); PG8_BAR; PG8_WAIT_L(0); PG8_MMA(0, 0, At, B0); PG8_BAR; PG8_SCHED;
            PG8_LDB(B1, 1, 1); PG8_STAGE(PG8_SB(1, 0), b3, voffB);
            PG8_BAR; PG8_WAIT_L(0); PG8_MMA(0, 1, At, B1); PG8_BAR;
            PG8_LDA(At, 1, 1); PG8_STAGE(PG8_SA(1, 0), a3, voffA);
            PG8_BAR; PG8_WAIT_L(0); PG8_MMA(1, 0, At, B0); PG8_BAR; PG8_SCHED;
            PG8_STAGE(PG8_SB(1, 1), b3 + hstep, voffB);
            PG8_WAIT_V(6); PG8_BAR; PG8_MMA(1, 1, At, B1); PG8_BAR;
        }
        E(acc, cur, wr, wc, fr, fq);
        if (!has_next) break;
#pragma unroll
        for (int a = 0; a < 2; ++a)
#pragma unroll
            for (int b = 0; b < 2; ++b)
#pragma unroll
                for (int m = 0; m < 4; ++m)
#pragma unroll
                    for (int n = 0; n < 2; ++n) acc[a][b][m][n] = (f32x4){0.f, 0.f, 0.f, 0.f};
        cur = nxt; cA = nA; cB = nB; ++ui;
    }
    PG8_WAIT_V(0);
    if (wr == 0) PG8_BAR;
    PG8_BAR;
#undef PG8_SA
#undef PG8_SB
#undef PG8_STAGE
#undef PG8_LDA
#undef PG8_LDB
#undef PG8_MMA
#undef PG8_WAIT_V
#undef PG8_WAIT_L
#undef PG8_BAR
#undef PG8_SCHED
}
}

typedef f32x4 AccT[2][2][4][2];
__device__ __forceinline__ u32x4 pack8(const f32x4 a, const f32x4 b) { u32x4 w; w.x = cvt_pk_bf16(a[0], a[1]); w.y = cvt_pk_bf16(a[2], a[3]); w.z = cvt_pk_bf16(b[0], b[1]); w.w = cvt_pk_bf16(b[2], b[3]); return w; }
__device__ __forceinline__ float rs_of(const float* rowss, int row) { return rsqrtf(rowss[row] * (1.0f / D) + EPS); }

struct EpiU {
    bf16_t* O; const float* rowss;
    __device__ __forceinline__ void operator()(const AccT& acc, const pg8::Unit& u, int wr, int wc, int fr, int fq) const {
        const int row0 = u.pm * 256 + wr * 64 + fr, col0 = u.pn * 256 + wc * 32 + 8 * fq;
#pragma unroll
        for (int ai = 0; ai < 2; ++ai)
#pragma unroll
            for (int m = 0; m < 4; ++m) { const int row = row0 + ai * 128 + m * 16; const float rs = rs_of(rowss, row);
#pragma unroll
                for (int bj = 0; bj < 2; ++bj) *(u32x4*)(O + (size_t)row * D + col0 + bj * 128) = pack8(acc[ai][bj][m][0] * rs, acc[ai][bj][m][1] * rs); }
    }
};
struct EpiGluRes {
    const float* xp; const float* xs; float* xres; bf16_t* xb; float* rowss;
    __device__ __forceinline__ void operator()(const AccT& acc, const pg8::Unit& u, int wr, int wc, int fr, int fq) const {
        const int row0 = u.pm * 256 + wr * 64 + fr, col0 = u.pn * 128 + wc * 32 + 8 * fq;
        const float* xold = (u.pm < MP / 256) ? xp : xs - (size_t)MP * D;
#pragma unroll
        for (int ai = 0; ai < 2; ++ai)
#pragma unroll
            for (int m = 0; m < 4; ++m) { const int row = row0 + ai * 128 + m * 16; const size_t off = (size_t)row * D + col0;
                const f32x4 o0 = *(const f32x4*)(xold + off), o1 = *(const f32x4*)(xold + off + 4);
                f32x4 v0, v1;
#pragma unroll
                for (int j = 0; j < 4; ++j) { v0[j] = o0[j] + acc[ai][0][m][0][j] * sigmoid_f(acc[ai][1][m][0][j]); v1[j] = o1[j] + acc[ai][0][m][1][j] * sigmoid_f(acc[ai][1][m][1][j]); }
                *(f32x4*)(xres + off) = v0; *(f32x4*)(xres + off + 4) = v1; *(u32x4*)(xb + off) = pack8(v0, v1);
                float ss = (v0[0] * v0[0] + v0[1] * v0[1]) + (v0[2] * v0[2] + v0[3] * v0[3]) + (v1[0] * v1[0] + v1[1] * v1[1]) + (v1[2] * v1[2] + v1[3] * v1[3]);
                ss += __shfl_xor(ss, 16); ss += __shfl_xor(ss, 32);
                if (fq == 0) atomicAdd(rowss + row, ss); }
    }
};
struct EpiSwiglu {
    bf16_t* H; const float* rowss;
    __device__ __forceinline__ void operator()(const AccT& acc, const pg8::Unit& u, int wr, int wc, int fr, int fq) const {
        const int row0 = u.pm * 256 + wr * 64 + fr, col0 = u.pn * 128 + wc * 32 + 8 * fq;
#pragma unroll
        for (int ai = 0; ai < 2; ++ai)
#pragma unroll
            for (int m = 0; m < 4; ++m) { const int row = row0 + ai * 128 + m * 16; const float rs = rs_of(rowss, row);
                f32x4 v0, v1;
#pragma unroll
                for (int j = 0; j < 4; ++j) { v0[j] = silu_f(rs * acc[ai][0][m][0][j]) * (rs * acc[ai][1][m][0][j]); v1[j] = silu_f(rs * acc[ai][0][m][1][j]) * (rs * acc[ai][1][m][1][j]); }
                *(u32x4*)(H + (size_t)row * FF + col0) = pack8(v0, v1); }
    }
};
struct EpiRes {
    float* xres; bf16_t* xb; float* rowss;
    __device__ __forceinline__ void operator()(const AccT& acc, const pg8::Unit& u, int wr, int wc, int fr, int fq) const {
        const int row0 = u.pm * 256 + wr * 64 + fr, col0 = u.pn * 256 + wc * 32 + 8 * fq;
#pragma unroll
        for (int ai = 0; ai < 2; ++ai)
#pragma unroll
            for (int m = 0; m < 4; ++m) { const int row = row0 + ai * 128 + m * 16; float ss = 0.f;
#pragma unroll
                for (int bj = 0; bj < 2; ++bj) { const size_t off = (size_t)row * D + col0 + bj * 128;
                    const f32x4 v0 = *(const f32x4*)(xres + off) + acc[ai][bj][m][0], v1 = *(const f32x4*)(xres + off + 4) + acc[ai][bj][m][1];
                    *(f32x4*)(xres + off) = v0; *(f32x4*)(xres + off + 4) = v1; if (xb) *(u32x4*)(xb + off) = pack8(v0, v1);
                    ss += (v0[0] * v0[0] + v0[1] * v0[1]) + (v0[2] * v0[2] + v0[3] * v0[3]) + (v1[0] * v1[0] + v1[1] * v1[1]) + (v1[2] * v1[2] + v1[3] * v1[3]); }
                ss += __shfl_xor(ss, 16); ss += __shfl_xor(ss, 32);
                if (fq == 0) atomicAdd(rowss + row, ss); }
    }
};
struct EpiGmlpIn {
    bf16_t* UG; float* ZV; const float* rowss; float* vsum; float* vsq;
    __device__ __forceinline__ void operator()(const AccT& acc, const pg8::Unit& u, int wr, int wc, int fr, int fq) const {
        const int row0 = u.pm * 256 + wr * 64 + fr; const bool isv = u.pn >= 8; const int col0 = (u.pn & 7) * 256 + wc * 32 + 8 * fq;
#pragma unroll
        for (int ai = 0; ai < 2; ++ai)
#pragma unroll
            for (int m = 0; m < 4; ++m) { const int row = row0 + ai * 128 + m * 16; const float rs = rs_of(rowss, row); float s1 = 0.f, s2 = 0.f;
#pragma unroll
                for (int bj = 0; bj < 2; ++bj) { const size_t off = (size_t)row * D + col0 + bj * 128; f32x4 v0, v1;
#pragma unroll
                    for (int j = 0; j < 4; ++j) { v0[j] = gelu_tanh(rs * acc[ai][bj][m][0][j]); v1[j] = gelu_tanh(rs * acc[ai][bj][m][1][j]); }
                    if (!isv) *(u32x4*)(UG + off) = pack8(v0, v1);
                    else { *(f32x4*)(ZV + off) = v0; *(f32x4*)(ZV + off + 4) = v1;
                        s1 += (v0[0] + v0[1]) + (v0[2] + v0[3]) + (v1[0] + v1[1]) + (v1[2] + v1[3]);
                        s2 += (v0[0] * v0[0] + v0[1] * v0[1]) + (v0[2] * v0[2] + v0[3] * v0[3]) + (v1[0] * v1[0] + v1[1] * v1[1]) + (v1[2] * v1[2] + v1[3] * v1[3]); } }
                if (isv) { s1 += __shfl_xor(s1, 16); s1 += __shfl_xor(s1, 32); s2 += __shfl_xor(s2, 16); s2 += __shfl_xor(s2, 32);
                    if (fq == 0) { atomicAdd(vsum + row, s1); atomicAdd(vsq + row, s2); } } }
    }
};

__device__ __forceinline__ void convert_job(LAS float* tile, const float* __restrict__ src, bf16_t* __restrict__ dst, const float* __restrict__ gain, int K, int Nsrc, int Ndst, int half) {
    const int tid = threadIdx.x, nk = K / 128, ntile = (Ndst / 64) * nk;
    for (int t = blockIdx.x; t < ntile; t += gridDim.x) {
        const int tn = t / nk, tk = t - tn * nk, n0 = tn * 64;
        int sc0 = n0;
        if (half) { const int pn = n0 >> 8, w = n0 & 255; sc0 = (w < 128) ? pn * 128 + w : half + pn * 128 + (w - 128); }
        { const int c4 = tid & 15, kr = tid >> 4;
#pragma unroll
          for (int ps = 0; ps < 4; ++ps) { const int k = kr + 32 * ps; const f32x4 v = *(const f32x4*)(src + (size_t)(tk * 128 + k) * Nsrc + sc0 + 4 * c4);
              tile[k * 65 + 4 * c4 + 0] = v[0]; tile[k * 65 + 4 * c4 + 1] = v[1]; tile[k * 65 + 4 * c4 + 2] = v[2]; tile[k * 65 + 4 * c4 + 3] = v[3]; } }
        __syncthreads();
        { const int kc = tid & 15, nr = tid >> 4, k0 = kc * 8;
          float gk[8];
#pragma unroll
          for (int j = 0; j < 8; ++j) gk[j] = gain ? gain[tk * 128 + k0 + j] : 1.0f;
#pragma unroll
          for (int ps = 0; ps < 2; ++ps) { const int n = nr + 32 * ps; float v[8];
#pragma unroll
              for (int j = 0; j < 8; ++j) v[j] = tile[(k0 + j) * 65 + n] * gk[j];
              u32x4 w; w.x = cvt_pk_bf16(v[0], v[1]); w.y = cvt_pk_bf16(v[2], v[3]); w.z = cvt_pk_bf16(v[4], v[5]); w.w = cvt_pk_bf16(v[6], v[7]);
              *(u32x4*)(dst + (size_t)(n0 + n) * K + tk * 128 + k0) = w; } }
        __syncthreads();
    }
}

__device__ __forceinline__ void phase_prep(LAS unsigned char* lds, const Args& a) {
    unsigned char* ws = a.ws;
    const int tid = threadIdx.x, lane = tid & 63, wid = tid >> 6;
    const int gt = blockIdx.x * 512 + tid, nthr = gridDim.x * 512;
    float* stats = (float*)(ws + WS_STATS);
    for (int i = gt; i < 6 * M; i += nthr) stats[M + i] = 0.f;
    if (gt < NG * NP) {
        const int g = gt >> 6, p = gt & 63;
        const float dt = expf(a.in[10][g]), lr = a.in[8][gt], li = a.in[9][gt];
        const float mag = expf(lr * dt), are = mag * cosf(li * dt), aim = mag * sinf(li * dt);
        const float den = lr * lr + li * li, nr = are - 1.0f, ni = aim;
        const float qre = (nr * lr + ni * li) / den, qim = (ni * lr - nr * li) / den;
        ((f32x2*)(ws + WS_ATAB))[gt] = (f32x2){are, aim};
        const float* bre = a.in[11] + (size_t)gt * NC; const float* bim = a.in[12] + (size_t)gt * NC;
        bf16_t* bbt = (bf16_t*)(ws + WS_BBT);
#pragma unroll
        for (int c = 0; c < NC; c += 2) {
            const float r0 = qre * bre[c] - qim * bim[c], i0 = qre * bim[c] + qim * bre[c];
            const float r1 = qre * bre[c + 1] - qim * bim[c + 1], i1 = qre * bim[c + 1] + qim * bre[c + 1];
            *(unsigned*)(bbt + ((size_t)(g * 128 + p) * 16 + c)) = cvt_pk_bf16(r0, r1);
            *(unsigned*)(bbt + ((size_t)(g * 128 + 64 + p) * 16 + c)) = cvt_pk_bf16(i0, i1);
        }
        bf16_t* cmt = (bf16_t*)(ws + WS_CMT);
#pragma unroll
        for (int c = 0; c < NC; ++c) {
            const float cr = a.in[13][((size_t)g * NC + c) * NP + p], ci = a.in[14][((size_t)g * NC + c) * NP + p];
            *(unsigned*)(cmt + ((size_t)(g * 16 + c) * 128 + 2 * p)) = cvt_pk_bf16(cr, -ci);
        }
    }
    { bf16_t* xb = (bf16_t*)(ws + WS_XB);
      for (int r = blockIdx.x * 8 + wid; r < M; r += gridDim.x * 8) {
          const float* src = (r < MP) ? a.in[0] + (size_t)r * D : a.in[1] + (size_t)(r - MP) * D; float ss = 0.f;
#pragma unroll
          for (int i = 0; i < 8; ++i) { const f32x4 v = *(const f32x4*)(src + i * 256 + lane * 4);
              ss += (v[0] * v[0] + v[1] * v[1]) + (v[2] * v[2] + v[3] * v[3]);
              u32x2 w; w.x = cvt_pk_bf16(v[0], v[1]); w.y = cvt_pk_bf16(v[2], v[3]); *(u32x2*)(xb + (size_t)r * D + i * 256 + lane * 4) = w; }
          ss = wave_sum(ss); if (lane == 0) stats[r] = ss; } }
    LAS float* tile = (LAS float*)lds;
    convert_job(tile, a.in[7],  (bf16_t*)(ws + WS_W1),   a.in[4],      D,  D,     D,     0);
    convert_job(tile, a.in[16], (bf16_t*)(ws + WS_W2),   nullptr,      D,  2 * D, 2 * D, D);
    convert_job(tile, a.in[22], (bf16_t*)(ws + WS_WGU0), a.in[5],      D,  NGU,   NGU,   FF);
    convert_job(tile, a.in[23], (bf16_t*)(ws + WS_WD0),  nullptr,      FF, D,     D,     0);
    convert_job(tile, a.in[17], (bf16_t*)(ws + WS_W5),   a.in[4] + D,  D,  2 * D, 2 * D, 0);
    convert_job(tile, a.in[21], (bf16_t*)(ws + WS_W6),   nullptr,      D,  D,     D,     0);
    convert_job(tile, a.in[22] + (size_t)D * NGU, (bf16_t*)(ws + WS_WGU1), a.in[5] + D, D,  NGU, NGU, FF);
    convert_job(tile, a.in[23] + (size_t)FF * D,  (bf16_t*)(ws + WS_WD1),  nullptr,     FF, D,   D,   0);
}

constexpr int BU_P = 132, S_P = 68, SSM_WAVE_LDS = 16 * BU_P * 4 + 16 * S_P * 4;
template <bool PASS_B>
__device__ __forceinline__ void ssm_pass(LAS unsigned char* lds, const Args& a) {
    unsigned char* ws = a.ws;
    const int tid = threadIdx.x, lane = tid & 63, wid = tid >> 6, fr = lane & 15, fq = lane >> 4;
    LAS float* BU = (LAS float*)(lds + wid * SSM_WAVE_LDS);
    LAS unsigned* S = (LAS unsigned*)(lds + wid * SSM_WAVE_LDS + 16 * BU_P * 4);
    const bf16_t* U = (const bf16_t*)(ws + WS_U); bf16_t* Z = (bf16_t*)(ws + WS_Z);
    const f32x2* atab = (const f32x2*)(ws + WS_ATAB); const bf16_t* bbt = (const bf16_t*)(ws + WS_BBT); const bf16_t* cmt = (const bf16_t*)(ws + WS_CMT);
    f32x2* sloc = (f32x2*)(ws + WS_SLOC);
    const int nitems = PASS_B ? (4 * NG * 16 + 128 * NG) : (4 * NG * 15);
    const bf16x8 zero8 = (bf16x8){0, 0, 0, 0, 0, 0, 0, 0};
    for (int item = blockIdx.x * 8 + wid; item < nitems; item += gridDim.x * 8) {
        const bool sample = PASS_B && item >= 4 * NG * 16;
        int g, b, ch, row0, nblk, nvalid;
        if (!sample) { g = item & 127; const int bc = item >> 7; if (PASS_B) { ch = bc & 15; b = bc >> 4; } else { ch = bc % 15; b = bc / 15; } row0 = b * SEQ + ch * CH; nblk = 8; nvalid = 16; }
        else { const int it = item - 4 * NG * 16; g = it & 127; b = it >> 7; ch = 0; row0 = MP + b * 4; nblk = 1; nvalid = 4; }
        const f32x2 av = atab[g * 64 + lane];
        bf16x8 bbf[8];
#pragma unroll
        for (int blk = 0; blk < 8; ++blk) bbf[blk] = (fq < 2) ? *(const bf16x8*)(bbt + ((size_t)(g * 128 + blk * 16 + fr) * 16 + fq * 8)) : zero8;
        bf16x8 cmf[4]; float dsk[4];
        if (PASS_B) {
#pragma unroll
            for (int kk = 0; kk < 4; ++kk) cmf[kk] = *(const bf16x8*)(cmt + ((size_t)(g * 16 + fr) * 128 + kk * 32 + fq * 8));
#pragma unroll
            for (int j = 0; j < 4; ++j) dsk[j] = a.in[15][g * 16 + 4 * fq + j];
        }
        float sre = 0.f, sim = 0.f;
        if (PASS_B) {
            if (sample) { sre = a.in[2][((size_t)b * NG + g) * NP + lane]; sim = a.in[3][((size_t)b * NG + g) * NP + lane]; }
            else if (ch > 0) {
                float pr = av.x, pi = av.y;
#pragma unroll
                for (int i = 0; i < 7; ++i) { const float nr = pr * pr - pi * pi, ni = 2.f * pr * pi; pr = nr; pi = ni; }
                for (int c = 0; c < ch; ++c) { const f32x2 l = sloc[((size_t)(b * NG + g) * 16 + c) * NP + lane];
                    const float nr = pr * sre - pi * sim + l.x, ni = pr * sim + pi * sre + l.y; sre = nr; sim = ni; }
            }
        }
        for (int tb = 0; tb < nblk; ++tb) {
            const int rowb = row0 + tb * 16;
            bf16x8 uf = zero8;
            if (fq < 2 && fr < nvalid) uf = *(const bf16x8*)(U + (size_t)(rowb + fr) * D + g * 16 + fq * 8);
#pragma unroll
            for (int blk = 0; blk < 8; ++blk) { const f32x4 c = __builtin_amdgcn_mfma_f32_16x16x32_bf16(bbf[blk], uf, (f32x4){0.f, 0.f, 0.f, 0.f}, 0, 0, 0);
                *(LAS f32x4*)(BU + fr * BU_P + blk * 16 + 4 * fq) = c; }
            asm volatile("s_waitcnt lgkmcnt(0)" ::: "memory"); __builtin_amdgcn_wave_barrier();
            for (int t = 0; t < nvalid; ++t) {
                const float bre = BU[t * BU_P + lane], bim = BU[t * BU_P + 64 + lane];
                const float nr = av.x * sre - av.y * sim + bre, ni = av.x * sim + av.y * sre + bim; sre = nr; sim = ni;
                if (PASS_B) S[t * S_P + lane] = cvt_pk_bf16(sre, sim);
            }
            if (PASS_B) {
                asm volatile("s_waitcnt lgkmcnt(0)" ::: "memory"); __builtin_amdgcn_wave_barrier();
                f32x4 y = (f32x4){0.f, 0.f, 0.f, 0.f};
#pragma unroll
                for (int kk = 0; kk < 4; ++kk) { const bf16x8 sf = *(const LAS bf16x8*)(S + fr * S_P + kk * 16 + fq * 4); y = __builtin_amdgcn_mfma_f32_16x16x32_bf16(cmf[kk], sf, y, 0, 0, 0); }
                if (fr < nvalid) { const size_t off = (size_t)(rowb + fr) * D + g * 16 + 4 * fq;
                    const u32x2 uw = *(const u32x2*)(U + off);
                    const float z0 = gelu_tanh(y[0] + dsk[0] * bf_lo(uw.x)), z1 = gelu_tanh(y[1] + dsk[1] * bf_hi(uw.x));
                    const float z2 = gelu_tanh(y[2] + dsk[2] * bf_lo(uw.y)), z3 = gelu_tanh(y[3] + dsk[3] * bf_hi(uw.y));
                    u32x2 zw; zw.x = cvt_pk_bf16(z0, z1); zw.y = cvt_pk_bf16(z2, z3); *(u32x2*)(Z + off) = zw; }
            }
            asm volatile("s_waitcnt lgkmcnt(0)" ::: "memory"); __builtin_amdgcn_wave_barrier();
        }
        if (!PASS_B) sloc[((size_t)(b * NG + g) * 16 + ch) * NP + lane] = (f32x2){sre, sim};
        else if (sample) { a.out[O_RE_S + ((size_t)b * NG + g) * NP + lane] = sre; a.out[O_IM_S + ((size_t)b * NG + g) * NP + lane] = sim; }
        else if (ch == 15) { a.out[O_RE_P + ((size_t)b * NG + g) * NP + lane] = sre; a.out[O_IM_P + ((size_t)b * NG + g) * NP + lane] = sim; }
    }
}

constexpr int SP_P = 136;
__device__ __forceinline__ void phase_spatial(LAS unsigned char* lds, const Args& a) {
    unsigned char* ws = a.ws;
    const int tid = threadIdx.x, lane = tid & 63, wid = tid >> 6, fr = lane & 15, fq = lane >> 4;
    LAS bf16_t* WsL = (LAS bf16_t*)lds; LAS bf16_t* VtL = (LAS bf16_t*)(lds + 128 * SP_P * 2);
    const float* stats = (const float*)(ws + WS_STATS); const float* vsum = stats + 5 * M; const float* vsq = stats + 6 * M;
    const float* ZV = (const float*)(ws + WS_H); const bf16_t* UG = (const bf16_t*)(ws + WS_U); bf16_t* AO = (bf16_t*)(ws + WS_Z);
    const float* wsp = a.in[19]; const float* bsp = a.in[20]; const float* vg = a.in[18];
    for (int item = blockIdx.x; item < 4 * 16 * 16; item += gridDim.x) {
        const int head = item & 15, bc = item >> 4, row0 = bc * CH, c0 = head * 128;
        { const int k4 = tid & 31, qr = tid >> 5;
#pragma unroll
          for (int ps = 0; ps < 8; ++ps) { const int q = qr + 16 * ps; f32x4 v = *(const f32x4*)(wsp + ((size_t)head * CH + q) * CH + 4 * k4);
#pragma unroll
              for (int j = 0; j < 4; ++j) if (4 * k4 + j > q) v[j] = 0.f;
              u32x2 w; w.x = cvt_pk_bf16(v[0], v[1]); w.y = cvt_pk_bf16(v[2], v[3]); *(LAS u32x2*)(WsL + q * SP_P + 4 * k4) = w; } }
        { const int d4 = tid & 31, kr = tid >> 5; const f32x4 gn = *(const f32x4*)(vg + c0 + 4 * d4);
#pragma unroll
          for (int ps = 0; ps < 8; ++ps) { const int k = kr + 16 * ps, row = row0 + k;
              const float mean = vsum[row] * (1.0f / D), var = vsq[row] * (1.0f / D) - mean * mean, rstd = rsqrtf(var + EPS);
              const f32x4 v = *(const f32x4*)(ZV + (size_t)row * D + c0 + 4 * d4);
#pragma unroll
              for (int j = 0; j < 4; ++j) { const unsigned w = cvt_pk_bf16((v[j] - mean) * rstd * gn[j], 0.f); VtL[(4 * d4 + j) * SP_P + k] = (bf16_t)w; } } }
        __syncthreads();
        const int qb = wid >> 1, dh = wid & 1;
        f32x4 acc[2][4];
#pragma unroll
        for (int i = 0; i < 2; ++i)
#pragma unroll
            for (int j = 0; j < 4; ++j) acc[i][j] = (f32x4){0.f, 0.f, 0.f, 0.f};
        for (int ks = 0; ks <= qb; ++ks) {
            bf16x8 wf[2], vf[4];
#pragma unroll
            for (int mq = 0; mq < 2; ++mq) wf[mq] = *(const LAS bf16x8*)(WsL + (32 * qb + 16 * mq + fr) * SP_P + 32 * ks + 8 * fq);
#pragma unroll
            for (int nd = 0; nd < 4; ++nd) vf[nd] = *(const LAS bf16x8*)(VtL + (64 * dh + 16 * nd + fr) * SP_P + 32 * ks + 8 * fq);
#pragma unroll
            for (int mq = 0; mq < 2; ++mq)
#pragma unroll
                for (int nd = 0; nd < 4; ++nd) acc[mq][nd] = __builtin_amdgcn_mfma_f32_16x16x32_bf16(vf[nd], wf[mq], acc[mq][nd], 0, 0, 0);
        }
#pragma unroll
        for (int mq = 0; mq < 2; ++mq) { const int q = 32 * qb + 16 * mq + fr; const float bq = bsp[head * CH + q];
#pragma unroll
            for (int nd = 0; nd < 4; ++nd) { const size_t off = (size_t)(row0 + q) * D + c0 + 64 * dh + 16 * nd + 4 * fq;
                const u32x2 uw = *(const u32x2*)(UG + off);
                u32x2 ow; ow.x = cvt_pk_bf16(bf_lo(uw.x) * (acc[mq][nd][0] + bq), bf_hi(uw.x) * (acc[mq][nd][1] + bq));
                ow.y = cvt_pk_bf16(bf_lo(uw.y) * (acc[mq][nd][2] + bq), bf_hi(uw.y) * (acc[mq][nd][3] + bq));
                *(u32x2*)(AO + off) = ow; } }
        __syncthreads();
    }
    for (int idx = blockIdx.x * 512 + tid; idx < 128 * D; idx += gridDim.x * 512) {
        const int b = idx >> 11, c = idx & (D - 1), head = c >> 7; const float gn = vg[c];
        float v[4];
#pragma unroll
        for (int t = 0; t < 4; ++t) { const int row = MP + b * 4 + t;
            const float mean = vsum[row] * (1.0f / D), var = vsq[row] * (1.0f / D) - mean * mean, rstd = rsqrtf(var + EPS);
            v[t] = (ZV[(size_t)row * D + c] - mean) * rstd * gn;
            a.out[O_V + ((size_t)b * 4 + t) * D + c] = v[t]; }
#pragma unroll
        for (int q = 0; q < 4; ++q) { float s = bsp[head * CH + q];
#pragma unroll
            for (int k = 0; k <= q; ++k) s += wsp[((size_t)head * CH + q) * CH + k] * v[k];
            const size_t off = (size_t)(MP + b * 4 + q) * D + c;
            const float ug = __uint_as_float(((unsigned)UG[off]) << 16);
            AO[off] = (bf16_t)cvt_pk_bf16(ug * s, 0.f); }
    }
}

__device__ __forceinline__ void phase_final(const Args& a) {
    const int lane = threadIdx.x & 63, wid = threadIdx.x >> 6;
    const float* rowss = (const float*)(a.ws + WS_STATS) + 4 * M; const float* gf = a.in[6];
    for (int r = blockIdx.x * 8 + wid; r < M; r += gridDim.x * 8) {
        const float rs = rs_of(rowss, r); float* p = a.out + (size_t)r * D;
#pragma unroll
        for (int i = 0; i < 8; ++i) { const int c = i * 256 + lane * 4; const f32x4 v = *(const f32x4*)(p + c), g = *(const f32x4*)(gf + c); *(f32x4*)(p + c) = v * rs * g; }
    }
}

__global__ void __launch_bounds__(512, 2) fwd_kernel(Args a) {
    extern __shared__ __attribute__((aligned(16))) unsigned char lds_raw[];
    LAS unsigned char* lds = (LAS unsigned char*)lds_raw;
    cg::grid_group grid = cg::this_grid();
    unsigned char* ws = a.ws;
    float* stats = (float*)(ws + WS_STATS);
    bf16_t* XB = (bf16_t*)(ws + WS_XB); bf16_t* UB = (bf16_t*)(ws + WS_U); bf16_t* ZB = (bf16_t*)(ws + WS_Z); bf16_t* HB = (bf16_t*)(ws + WS_H);
    float* xres = a.out;
    const int lo = a.ph_lo, hi = a.ph_hi;
#define IN(k) (lo <= (k) && (k) < hi)
#define SEAM(k) do { if (IN(k) && IN((k) + 1)) grid.sync(); } while (0)
    if (IN(0)) { phase_prep(lds, a); } SEAM(0);
    if (IN(1)) { pg8::Gemm g{XB, (const bf16_t*)(ws + WS_W1), M, D, D}; pg8::StaticOrder S; S.init(M, D, gridDim.x, blockIdx.x);
        EpiU E{UB, stats}; pg8::gemm_phase(lds, g, S, E); } SEAM(1);
    if (IN(2)) { ssm_pass<false>(lds, a); } SEAM(2);
    if (IN(3)) { ssm_pass<true>(lds, a); } SEAM(3);
    if (IN(4)) { pg8::Gemm g{ZB, (const bf16_t*)(ws + WS_W2), M, 2 * D, D}; pg8::StaticOrder S; S.init(M, 2 * D, gridDim.x, blockIdx.x);
        EpiGluRes E{a.in[0], a.in[1], xres, XB, stats + M}; pg8::gemm_phase(lds, g, S, E); } SEAM(4);
    if (IN(5)) { pg8::Gemm g{XB, (const bf16_t*)(ws + WS_WGU0), M, NGU, D}; pg8::StaticOrder S; S.init(M, NGU, gridDim.x, blockIdx.x);
        EpiSwiglu E{HB, stats + M}; pg8::gemm_phase(lds, g, S, E); } SEAM(5);
    if (IN(6)) { pg8::Gemm g{HB, (const bf16_t*)(ws + WS_WD0), M, D, FF}; pg8::StaticOrder S; S.init(M, D, gridDim.x, blockIdx.x);
        EpiRes E{xres, XB, stats + 2 * M}; pg8::gemm_phase(lds, g, S, E); } SEAM(6);
    if (IN(7)) { pg8::Gemm g{XB, (const bf16_t*)(ws + WS_W5), M, 2 * D, D}; pg8::StaticOrder S; S.init(M, 2 * D, gridDim.x, blockIdx.x);
        EpiGmlpIn E{UB, (float*)(ws + WS_H), stats + 2 * M, stats + 5 * M, stats + 6 * M}; pg8::gemm_phase(lds, g, S, E); } SEAM(7);
    if (IN(8)) { phase_spatial(lds, a); } SEAM(8);
    if (IN(9)) { pg8::Gemm g{ZB, (const bf16_t*)(ws + WS_W6), M, D, D}; pg8::StaticOrder S; S.init(M, D, gridDim.x, blockIdx.x);
        EpiRes E{xres, XB, stats + 3 * M}; pg8::gemm_phase(lds, g, S, E); } SEAM(9);
    if (IN(10)) { pg8::Gemm g{XB, (const bf16_t*)(ws + WS_WGU1), M, NGU, D}; pg8::StaticOrder S; S.init(M, NGU, gridDim.x, blockIdx.x);
        EpiSwiglu E{HB, stats + 3 * M}; pg8::gemm_phase(lds, g, S, E); } SEAM(10);
    if (IN(11)) { pg8::Gemm g{HB, (const bf16_t*)(ws + WS_WD1), M, D, FF}; pg8::StaticOrder S; S.init(M, D, gridDim.x, blockIdx.x);
        EpiRes E{xres, nullptr, stats + 4 * M}; pg8::gemm_phase(lds, g, S, E); } SEAM(11);
    if (IN(12)) { phase_final(a); }
#undef IN
#undef SEAM
}

extern "C" void kernel_launch(void* const* d_in, const int* in_sizes, int n_in, void* d_out, int out_size, void* d_ws, size_t ws_size, hipStream_t stream) {
    constexpr int LDS_BYTES = pg8::STAGE_BYTES;
    static int grid = 0;
    if (grid == 0) {
        if (n_in != 24 || ws_size < WS_END) { fprintf(stderr, "kernel_launch: unexpected n_in %d / ws_size %zu (need %zu)\n", n_in, ws_size, (size_t)WS_END); grid = -1; return; }
        int dev = 0, cus = 0, per_cu = 0;
        hipGetDevice(&dev); hipDeviceGetAttribute(&cus, hipDeviceAttributeMultiprocessorCount, dev);
        if (hipFuncSetAttribute((const void*)fwd_kernel, hipFuncAttributeMaxDynamicSharedMemorySize, LDS_BYTES) != hipSuccess) { fprintf(stderr, "kernel_launch: hipFuncSetAttribute failed\n"); grid = -1; return; }
        if (hipOccupancyMaxActiveBlocksPerMultiprocessor(&per_cu, (const void*)fwd_kernel, 512, LDS_BYTES) != hipSuccess || per_cu < 1) { fprintf(stderr, "kernel_launch: occupancy query says %d\n", per_cu); per_cu = 1; }
        (void)hipGetLastError();
        grid = cus * 1;
    }
    if (grid < 0) return;
    Args a{};
    for (int i = 0; i < 24; ++i) a.in[i] = (const float*)d_in[i];
    a.out = (float*)d_out; a.ws = (unsigned char*)d_ws;
#if N_LAUNCH_MODE == 1
    a.ph_lo = 0; a.ph_hi = NPHASE;
    { void* args[] = {&a};
      hipError_t e = hipLaunchCooperativeKernel((const void*)fwd_kernel, dim3(grid), dim3(512), args, LDS_BYTES, stream);
      if (e != hipSuccess) fprintf(stderr, "cooperative launch failed: %s (grid %d)\n", hipGetErrorString(e), grid); }
#else
    for (int ph = 0; ph < NPHASE; ++ph) {
        a.ph_lo = ph; a.ph_hi = ph + 1;
        void* args[] = {&a};
        hipError_t e = hipLaunchCooperativeKernel((const void*)fwd_kernel, dim3(grid), dim3(512), args, LDS_BYTES, stream);
        if (e != hipSuccess) { fprintf(stderr, "launch of phase %d failed: %s (grid %d)\n", ph, hipGetErrorString(e), grid); break; }
    }
#endif
}
```
